# Optimizing an MI355X kernel written in HIP

```python
import jax, jax.numpy as jnp
from jax import lax
import numpy as np

D_MODEL = 1024
BATCH = 8
SEQ = 4096
DEPTH = 2
DEC_BATCH = 1
DEC_SEQ = 16384
PAST_LEN = 128

GRID_W = 64
N_HEADS = 16
HEAD_DIM = D_MODEL // N_HEADS
MAX_KH = 8
KW = 16
KB = min(2 * KW, GRID_W)
CONV_W = 3
D_FF = 2816
N_MIXERS = 2
N_NA = (DEPTH + 1) // 2
N_SC = DEPTH // 2
EPS = 1e-6
NEG_INF = -1e30

kernel_name = "hybrid_natten_shortconv_encoder"


def rmsnorm(x, g):
    x32 = x.astype(jnp.float32)
    y = x32 * lax.rsqrt(jnp.mean(x32 * x32, axis=-1, keepdims=True) + EPS)
    return (y * g.astype(jnp.float32)).astype(x.dtype)


def conv3_centered(x, w):
    xp = jnp.pad(x, ((0, 0), (1, 1), (0, 0)))
    return xp[:, :-2] * w[0] + xp[:, 1:-1] * w[1] + xp[:, 2:] * w[2]


def neighbourhood_attention(q, k, v, rpb):
    bsz, t, h, dh = q.shape
    rows = t // GRID_W
    kh = min(MAX_KH, rows)
    ncb = GRID_W // KW
    scale = dh ** -0.5
    qg = q.reshape(bsz, rows, GRID_W, h, dh).transpose(0, 3, 1, 2, 4)
    kg = k.reshape(bsz, rows, GRID_W, h, dh).transpose(0, 3, 1, 2, 4)
    vg = v.reshape(bsz, rows, GRID_W, h, dh).transpose(0, 3, 1, 2, 4)
    cols = np.arange(GRID_W)
    col_start = np.clip(cols - KW // 2, 0, GRID_W - KW).reshape(ncb, KW)
    q_cols = cols.reshape(ncb, KW)
    blk_start = np.clip(np.arange(ncb) * KW - KW // 2, 0, GRID_W - KB)
    key_cols = blk_start[:, None] + np.arange(KB)[None, :]
    kc = key_cols[:, None, :]
    col_valid = (kc >= col_start[..., None]) & (kc < col_start[..., None] + KW)
    dc_idx = np.clip(kc - q_cols[..., None] + KW - 1, 0, 2 * KW - 2)
    mask = jnp.asarray(col_valid)[None, None, :, :, None, :]

    def row_block(r):
        rs = jnp.clip(r - kh // 2, 0, rows - kh)
        qr = lax.dynamic_index_in_dim(qg, r, axis=2, keepdims=False)
        kband = lax.dynamic_slice_in_dim(kg, rs, kh, axis=2)
        vband = lax.dynamic_slice_in_dim(vg, rs, kh, axis=2)
        kblk = kband[:, :, :, key_cols]
        vblk = vband[:, :, :, key_cols]
        qb = qr.reshape(bsz, h, ncb, KW, dh)
        s = jnp.einsum('bhjqd,bhijkd->bhjqik', qb, kblk,
                       preferred_element_type=jnp.float32) * scale
        dr = rs + jnp.arange(kh) - r
        rpb_r = rpb[:, dr + MAX_KH - 1]
        bias = rpb_r[:, :, dc_idx].transpose(0, 2, 3, 1, 4)
        s = jnp.where(mask, s + bias.astype(jnp.float32)[None], NEG_INF)
        p = jax.nn.softmax(s, axis=(-2, -1))
        o = jnp.einsum('bhjqik,bhijkd->bhjqd', p.astype(vblk.dtype), vblk)
        return o.reshape(bsz, h, GRID_W, dh)

    out = lax.map(row_block, jnp.arange(rows))
    return out.transpose(1, 0, 3, 2, 4).reshape(bsz, t, h * dh)


def na_mixer(x, w_qkv, b_qkv, rpb, w_o):
    bsz, t, _ = x.shape
    qkv = jnp.dot(x, w_qkv) + b_qkv
    q, k, v = jnp.split(qkv, 3, axis=-1)
    shp = (bsz, t, N_HEADS, HEAD_DIM)
    o = neighbourhood_attention(q.reshape(shp), k.reshape(shp), v.reshape(shp), rpb)
    return jnp.dot(o, w_o)


def short_conv_mixer(x, w_in, conv_w, w_out):
    bg, cg, u = jnp.split(jnp.dot(x, w_in), 3, axis=-1)
    y = conv3_centered(cg * u, conv_w)
    return jnp.dot(bg * y, w_out)


def conv_ffn(x, w_up, conv_w, conv_b, w_down):
    a, val = jnp.split(jnp.dot(x, w_up), 2, axis=-1)
    a = conv3_centered(a, conv_w) + conv_b
    return jnp.dot(jax.nn.silu(a) * val, w_down)


def trunk(x, c, p):
    for i in range(DEPTH):
        mod = jnp.dot(jax.nn.silu(c), p['ada_w'][i]) + p['ada_b'][i]
        sh1, sc1, g1, sh2, sc2, g2 = jnp.split(mod[:, None, :], 6, axis=-1)
        h = rmsnorm(x, p['norm1_g'][i]) * (1 + sc1) + sh1
        j = i // N_MIXERS
        if i % N_MIXERS == 0:
            m = na_mixer(h, p['na_w_qkv'][j], p['na_b_qkv'][j], p['na_rpb'][j], p['na_w_o'][j])
        else:
            m = short_conv_mixer(h, p['sc_w_in'][j], p['sc_conv_w'][j], p['sc_w_out'][j])
        x = x + g1 * m
        h = rmsnorm(x, p['norm2_g'][i]) * (1 + sc2) + sh2
        x = x + g2 * conv_ffn(h, p['ffn_w_up'][i], p['ffn_conv_w'][i], p['ffn_conv_b'][i], p['ffn_w_down'][i])
    return rmsnorm(x, p['final_g'])


def setup_inputs(seed: int = 0) -> dict:
    key = jax.random.key(seed)
    ks = jax.random.split(key, 20)
    D, F = D_MODEL, D_FF
    nrm = jax.random.normal
    return {
        'x_prompt': nrm(ks[0], (BATCH, SEQ, D), jnp.float32),
        'x_sample': nrm(ks[1], (DEC_BATCH, DEC_SEQ, D), jnp.float32),
        'c_prompt': nrm(ks[2], (BATCH, D), jnp.float32),
        'c_sample': nrm(ks[3], (DEC_BATCH, D), jnp.float32),
        'ada_w': nrm(ks[4], (DEPTH, D, 6 * D), jnp.float32) * (0.5 * D ** -0.5),
        'ada_b': nrm(ks[5], (DEPTH, 6 * D), jnp.float32) * 0.02,
        'norm1_g': 1.0 + 0.02 * nrm(ks[6], (DEPTH, D), jnp.float32),
        'norm2_g': 1.0 + 0.02 * nrm(ks[7], (DEPTH, D), jnp.float32),
        'na_w_qkv': nrm(ks[8], (N_NA, D, 3 * D), jnp.float32) * D ** -0.5,
        'na_b_qkv': nrm(ks[9], (N_NA, 3 * D), jnp.float32) * 0.02,
        'na_rpb': nrm(ks[10], (N_NA, N_HEADS, 2 * MAX_KH - 1, 2 * KW - 1), jnp.float32) * 0.1,
        'na_w_o': nrm(ks[11], (N_NA, D, D), jnp.float32) * D ** -0.5,
        'sc_w_in': nrm(ks[12], (N_SC, D, 3 * D), jnp.float32) * D ** -0.5,
        'sc_conv_w': nrm(ks[13], (N_SC, CONV_W, D), jnp.float32) * CONV_W ** -0.5,
        'sc_w_out': nrm(ks[14], (N_SC, D, D), jnp.float32) * D ** -0.5,
        'ffn_w_up': nrm(ks[15], (DEPTH, D, 2 * F), jnp.float32) * D ** -0.5,
        'ffn_conv_w': nrm(ks[16], (DEPTH, CONV_W, F), jnp.float32) * CONV_W ** -0.5,
        'ffn_conv_b': nrm(ks[17], (DEPTH, F), jnp.float32) * 0.02,
        'ffn_w_down': nrm(ks[18], (DEPTH, F, D), jnp.float32) * F ** -0.5,
        'final_g': 1.0 + 0.02 * nrm(ks[19], (D,), jnp.float32),
    }


def reference(x_prompt, x_sample, c_prompt, c_sample, ada_w, ada_b, norm1_g, norm2_g,
              na_w_qkv, na_b_qkv, na_rpb, na_w_o, sc_w_in, sc_conv_w, sc_w_out,
              ffn_w_up, ffn_conv_w, ffn_conv_b, ffn_w_down, final_g):
    p = dict(ada_w=ada_w, ada_b=ada_b, norm1_g=norm1_g, norm2_g=norm2_g,
             na_w_qkv=na_w_qkv, na_b_qkv=na_b_qkv, na_rpb=na_rpb, na_w_o=na_w_o,
             sc_w_in=sc_w_in, sc_conv_w=sc_conv_w, sc_w_out=sc_w_out,
             ffn_w_up=ffn_w_up, ffn_conv_w=ffn_conv_w, ffn_conv_b=ffn_conv_b,
             ffn_w_down=ffn_w_down, final_g=final_g)
    y_prompt = trunk(x_prompt, c_prompt, p)
    y_sample = trunk(x_sample, c_sample, p)
    return (y_prompt, y_sample)
```

```cpp
#include <hip/hip_runtime.h>
#include <hip/hip_cooperative_groups.h>
#include <cstdio>
#include <cstdint>
namespace cg = cooperative_groups;
namespace pg8 {
#define PG8_LAS __attribute__((address_space(3)))
typedef unsigned short bf16_t;
typedef short bf16x8 __attribute__((ext_vector_type(8)));
typedef float f32x4 __attribute__((ext_vector_type(4)));
typedef unsigned u32x4 __attribute__((ext_vector_type(4)));
constexpr int BM = 256, BK = 64, HALF = 128, HTB = HALF * BK * 2  , STAGE_BYTES = 8 * HTB, NXCD = 8, WGM = 8;

__host__ __device__ __forceinline__ int lds_byte(int r, int c) { const int st = (r >> 4) * 2 + (c >> 5), rr = r & 15, cc = c & 31, ob = rr * 64 + cc * 2; return st * 1024 + (ob ^ (((ob >> 9) & 1) << 5)); }
__host__ __device__ __forceinline__ void stage_rc(int b, int& R, int& C) { const int st = b / 1024, sb = b % 1024, swz = sb ^ (((sb >> 9) & 1) << 5); R = (st >> 1) * 16 + swz / 64; C = (st & 1) * 32 + (swz % 64) / 2; }
__host__ __device__ __forceinline__ int perm32(int rho) { const int n = rho >> 4, i = rho & 15; return 8 * (i >> 2) + 4 * n + (i & 3); }

struct Unit { int pm, pn; };
struct Gemm { const bf16_t* A; const bf16_t* Bt; int M, N, K; };

struct StaticOrder {
    int nM, nN, nwg, G, c;
    __host__ __device__ void init(int M, int N, int G_, int c_) { nM = M / BM; nN = N / BM; nwg = nM * nN; G = G_; c = c_; }
    __host__ __device__ bool next(int i, Unit& u) const {
        const long L = (long)i * G + c; if (L >= nwg) return false;
        int wgid = (int)L; { const int q = nwg / NXCD, r = nwg % NXCD, xcd = wgid % NXCD, off = wgid / NXCD; wgid = (xcd < r ? xcd * (q + 1) : r * (q + 1) + (xcd - r) * q) + off; }
        const int nig = WGM * nN, gid = wgid / nig, fm = gid * WGM, gsz = (nM - fm) < WGM ? (nM - fm) : WGM;
        u.pm = fm + ((wgid % nig) % gsz); u.pn = (wgid % nig) / gsz; return true;
    }
    __device__ __forceinline__ void a_ready(const Unit&) const {}
    __device__ __forceinline__ void done(const Unit&) const {}
};

__device__ __forceinline__ unsigned cvt_pk_bf16(float lo, float hi) { unsigned r; asm volatile("v_cvt_pk_bf16_f32 %0, %1, %2" : "=v"(r) : "v"(lo), "v"(hi)); return r; }
typedef float f32x2 __attribute__((ext_vector_type(2)));
__device__ __forceinline__ f32x2 gelu_pk(f32x2 v) {
    const f32x2 av = __builtin_elementwise_abs(v), d = av * 0.2316418882f + 1.0f;
    f32x2 t; t.x = __builtin_amdgcn_rcpf(d.x); t.y = __builtin_amdgcn_rcpf(d.y);
    f32x2 q = t * 0.5307027145f + (-0.7265760135f); q = q * t + 0.7107068705f; q = q * t + (-0.142248368f); q = q * t + 0.127414796f; q = q * t;
    const f32x2 s = (v * v) * (-0.72134752044f);
    f32x2 e; e.x = __builtin_amdgcn_exp2f(s.x); e.y = __builtin_amdgcn_exp2f(s.y);
    const f32x2 m = v * (q * e), r = v - m;
    f32x2 o; o.x = v.x < 0.f ? m.x : r.x; o.y = v.y < 0.f ? m.y : r.y; return o;
}

template <int ACT  > struct EpiBf16 {
    static constexpr bool PERM = true, AFTER_DRAIN = false; static_assert(ACT == 0 || ACT == 1, "EpiBf16: ACT is 0 (none) or 1 (gelu_pk)");
    bf16_t* O; int ldc; const float* bias; int split_cols; size_t split_stride; float scale0;
    __device__ __forceinline__ void operator()(const f32x4 (&acc)[2][2][4][2], const Unit& u, int wr, int wc, int fr, int fq) const {
        const int row0 = u.pm * BM + wr * 64 + fr; int colt = u.pn * BM; bf16_t* base = O;
        float sc = 1.f; if (split_cols) { const int t = colt / split_cols; base += (size_t)t * split_stride; colt -= t * split_cols; if (t == 0) sc = scale0; }
        const int col0 = colt + wc * 32 + 8 * fq, bcol0 = u.pn * BM + wc * 32 + 8 * fq;
        f32x4 bv[2][2];
#pragma unroll
        for (int bj = 0; bj < 2; ++bj)
#pragma unroll
            for (int n = 0; n < 2; ++n) bv[bj][n] = bias ? *(const f32x4*)(bias + bcol0 + bj * HALF + 4 * n) : (f32x4){0.f, 0.f, 0.f, 0.f};
#pragma unroll
        for (int ai = 0; ai < 2; ++ai)
#pragma unroll
            for (int m = 0; m < 4; ++m) { bf16_t* rowp = base + (size_t)(row0 + ai * HALF + m * 16) * ldc + col0;
#pragma unroll
                for (int bj = 0; bj < 2; ++bj) { f32x4 v0 = acc[ai][bj][m][0] + bv[bj][0], v1 = acc[ai][bj][m][1] + bv[bj][1];
                    if (ACT == 1) { f32x2 a = gelu_pk((f32x2){v0[0], v0[1]}), b = gelu_pk((f32x2){v0[2], v0[3]}), c = gelu_pk((f32x2){v1[0], v1[1]}), d = gelu_pk((f32x2){v1[2], v1[3]});
                        v0 = (f32x4){a.x, a.y, b.x, b.y}; v1 = (f32x4){c.x, c.y, d.x, d.y}; }
                    v0 = v0 * sc; v1 = v1 * sc; u32x4 w; w.x = cvt_pk_bf16(v0[0], v0[1]); w.y = cvt_pk_bf16(v0[2], v0[3]); w.z = cvt_pk_bf16(v1[0], v1[1]); w.w = cvt_pk_bf16(v1[2], v1[3]);
                    *(u32x4*)(rowp + bj * HALF) = w; } }
    }
};
__device__ __forceinline__ float dpp_ror1(float x)  { return __builtin_bit_cast(float, __builtin_amdgcn_update_dpp(0, __builtin_bit_cast(int, x), 0x121, 0xF, 0xF, false)); }
__device__ __forceinline__ float dpp_ror15(float x) { return __builtin_bit_cast(float, __builtin_amdgcn_update_dpp(0, __builtin_bit_cast(int, x), 0x12F, 0xF, 0xF, false)); }
__device__ __forceinline__ f32x4 rot_prev(f32x4 v) { return (f32x4){dpp_ror1(v[0]), dpp_ror1(v[1]), dpp_ror1(v[2]), dpp_ror1(v[3])}; }
__device__ __forceinline__ f32x4 rot_next(f32x4 v) { return (f32x4){dpp_ror15(v[0]), dpp_ror15(v[1]), dpp_ror15(v[2]), dpp_ror15(v[3])}; }
__device__ __forceinline__ float silu_f(float x) { return x * __builtin_amdgcn_rcpf(1.0f + __expf(-x)); }
__device__ __forceinline__ f32x4 silu4(f32x4 v) { return (f32x4){silu_f(v[0]), silu_f(v[1]), silu_f(v[2]), silu_f(v[3])}; }
__device__ __forceinline__ int seq_of_row(int m) { return m < 32768 ? (m >> 12) : 8; }

struct EpiBf16RowBias {
    static constexpr bool PERM = true, AFTER_DRAIN = false;
    bf16_t* O; int ldc; const float* bias;
    __device__ __forceinline__ void operator()(const f32x4 (&acc)[2][2][4][2], const Unit& u, int wr, int wc, int fr, int fq) const {
        const int row0 = u.pm * BM + wr * 64 + fr; const int col0 = u.pn * BM + wc * 32 + 8 * fq;
#pragma unroll
        for (int ai = 0; ai < 2; ++ai)
#pragma unroll
            for (int m = 0; m < 4; ++m) { const int r = row0 + ai * HALF + m * 16; const float b = bias[r]; bf16_t* rowp = O + (size_t)r * ldc + col0;
#pragma unroll
                for (int bj = 0; bj < 2; ++bj) { const f32x4 v0 = acc[ai][bj][m][0] + b, v1 = acc[ai][bj][m][1] + b;
                    u32x4 w; w.x = cvt_pk_bf16(v0[0], v0[1]); w.y = cvt_pk_bf16(v0[2], v0[3]); w.z = cvt_pk_bf16(v1[0], v1[1]); w.w = cvt_pk_bf16(v1[2], v1[3]);
                    *(u32x4*)(rowp + bj * HALF) = w; } }
    }
};

struct EpiResGate {
    static constexpr bool PERM = false, AFTER_DRAIN = false;
    const float* base_p; const float* base_s; float* out; const float* gate;
    __device__ __forceinline__ void operator()(const f32x4 (&acc)[2][2][4][2], const Unit& u, int wr, int wc, int fr, int fq) const {
        const int s = seq_of_row(u.pm * BM); const float* gp = gate + s * 6144;
        const int row0 = u.pm * BM + wr * 64 + fr, col0 = u.pn * BM + wc * 32 + 4 * fq;
        f32x4 gv[2][2];
#pragma unroll
        for (int bj = 0; bj < 2; ++bj)
#pragma unroll
            for (int n = 0; n < 2; ++n) gv[bj][n] = *(const f32x4*)(gp + col0 + bj * HALF + n * 16);
#pragma unroll
        for (int ai = 0; ai < 2; ++ai)
#pragma unroll
            for (int m = 0; m < 4; ++m) { const int r = row0 + ai * HALF + m * 16;
                const float* bp = (r < 32768 ? base_p + (size_t)r * 1024 : base_s + (size_t)(r - 32768) * 1024) + col0; float* op = out + (size_t)r * 1024 + col0;
#pragma unroll
                for (int bj = 0; bj < 2; ++bj)
#pragma unroll
                    for (int n = 0; n < 2; ++n) { const f32x4 b = *(const f32x4*)(bp + bj * HALF + n * 16); *(f32x4*)(op + bj * HALF + n * 16) = b + gv[bj][n] * acc[ai][bj][m][n]; } }
    }
};

struct EpiGate {
    static constexpr bool PERM = true, AFTER_DRAIN = false;
    bf16_t* G; const float* cw; const float* cb; float* edge;
    __device__ __forceinline__ void operator()(const f32x4 (&acc)[2][2][4][2], const Unit& u, int wr, int wc, int fr, int fq) const {
        constexpr int FFH = 2816; constexpr size_t ES = (size_t)768 * FFH;
        const int c0 = u.pn * HALF + wc * 32 + 8 * fq;
        f32x4 w0[2], w1[2], w2[2], bb[2];
#pragma unroll
        for (int n = 0; n < 2; ++n) { w0[n] = *(const f32x4*)(cw + c0 + 4 * n); w1[n] = *(const f32x4*)(cw + FFH + c0 + 4 * n); w2[n] = *(const f32x4*)(cw + 2 * FFH + c0 + 4 * n); bb[n] = *(const f32x4*)(cb + c0 + 4 * n); }
#pragma unroll
        for (int ai = 0; ai < 2; ++ai) {
            const int grp = u.pm * 4 + ai * 2 + wr, rowb = u.pm * BM + ai * HALF + wr * 64 + fr;
            float* eg = edge + (size_t)grp * FFH + c0;
#pragma unroll
            for (int m = 0; m < 4; ++m) {
                u32x4 pk;
#pragma unroll
                for (int n = 0; n < 2; ++n) {
                    const f32x4 cur = acc[ai][0][m][n], val = acc[ai][1][m][n];
                    const f32x4 rc = rot_prev(cur), lc = rot_next(cur);
                    const f32x4 rp = rot_prev(acc[ai][0][m > 0 ? m - 1 : 0][n]), ln = rot_next(acc[ai][0][m < 3 ? m + 1 : 3][n]);
                    const f32x4 prev = (fr == 0) ? rp : rc, next = (fr == 15) ? ln : lc;
                    const f32x4 mid = w1[n] * cur + bb[n];
                    const f32x4 o = silu4(mid + w0[n] * prev + w2[n] * next) * val;
                    if (m == 0) { if (fr == 0) { *(f32x4*)(eg + 0 * ES + 4 * n) = cur; *(f32x4*)(eg + 2 * ES + 4 * n) = mid + w2[n] * next; *(f32x4*)(eg + 4 * ES + 4 * n) = val; } }
                    if (m == 3) { if (fr == 15) { *(f32x4*)(eg + 1 * ES + 4 * n) = cur; *(f32x4*)(eg + 3 * ES + 4 * n) = mid + w0[n] * prev; *(f32x4*)(eg + 5 * ES + 4 * n) = val; } }
                    if (n == 0) { pk.x = cvt_pk_bf16(o[0], o[1]); pk.y = cvt_pk_bf16(o[2], o[3]); } else { pk.z = cvt_pk_bf16(o[0], o[1]); pk.w = cvt_pk_bf16(o[2], o[3]); }
                }
                *(u32x4*)(G + (size_t)(rowb + m * 16) * FFH + c0) = pk;
            }
        }
    }
};

template <class Epi, class Sched, bool ALIGN_EPI = false, bool SP2 = false>
__device__ __forceinline__ void gemm_phase(PG8_LAS unsigned char* lds, const Gemm g, const Sched& S, const Epi& E) {
    const int tid = threadIdx.x, wid = __builtin_amdgcn_readfirstlane(tid >> 6), lane = tid & 63, wr = wid >> 2, wc = wid & 3, fr = lane & 15, fq = lane >> 4;
    const int K = g.K, nt = K / BK;
    unsigned voffA[2], voffB[2];
#pragma unroll
    for (int i = 0; i < 2; ++i) { int R, C; stage_rc(tid * 16 + i * 8192, R, C); const int Rb = Epi::PERM ? ((R & ~31) + perm32(R & 31)) : R;
        voffA[i] = (unsigned)(R * K + C) * 2u; voffB[i] = (unsigned)(Rb * K + C) * 2u; }
    const size_t kstep = (size_t)(BK * 2);
    const size_t hstep = (size_t)HALF * K * 2;
    const size_t tstep = 2 * hstep;
    const unsigned ldsw = (unsigned)wid * 1024u;
    const int aoff = lds_byte(wr * 64 + fr, fq * 8), boff = lds_byte(wc * 32 + fr, fq * 8);
#define PG8_SA(b, h) (((b) * 2 + (h)) * HTB)
#define PG8_SB(b, h) ((4 + (b) * 2 + (h)) * HTB)
#define PG8_STAGE(bufoff, gbase, voff) do { _Pragma("unroll") for (int _i = 0; _i < 2; ++_i) \
        __builtin_amdgcn_global_load_lds((const unsigned*)((const char*)(gbase) + (voff)[_i]), (PG8_LAS unsigned*)(lds + (bufoff) + ldsw + _i * 8192), 16, 0, 0); } while (0)
#define PG8_LDA(dst, b, h) do { _Pragma("unroll") for (int m = 0; m < 4; ++m) _Pragma("unroll") for (int k = 0; k < 2; ++k) dst[m][k] = *(const PG8_LAS bf16x8*)(lds + PG8_SA(b, h) + aoff + m * 2048 + k * 1024); } while (0)
#define PG8_LDB(dst, b, h) do { _Pragma("unroll") for (int n = 0; n < 2; ++n) _Pragma("unroll") for (int k = 0; k < 2; ++k) dst[n][k] = *(const PG8_LAS bf16x8*)(lds + PG8_SB(b, h) + boff + n * 2048 + k * 1024); } while (0)
#define PG8_MMA(ai, bj, At, Bt) do { __builtin_amdgcn_s_setprio(1); _Pragma("unroll") for (int m = 0; m < 4; ++m) _Pragma("unroll") for (int n = 0; n < 2; ++n) _Pragma("unroll") for (int k = 0; k < 2; ++k) \
        acc[ai][bj][m][n] = __builtin_amdgcn_mfma_f32_16x16x32_bf16(Bt[n][k], At[m][k], acc[ai][bj][m][n], 0, 0, 0); __builtin_amdgcn_s_setprio(0); } while (0)
#define PG8_WAIT_V(n) asm volatile("s_waitcnt vmcnt(" #n ")" ::: "memory")
#define PG8_WAIT_L(n) asm volatile("s_waitcnt lgkmcnt(" #n ")" ::: "memory")
#define PG8_BAR __builtin_amdgcn_s_barrier()
#define PG8_SCHED __builtin_amdgcn_sched_barrier(0)
    Unit cur, nxt; int ui = 0;
    if (!S.next(0, cur)) return;
    f32x4 acc[2][2][4][2];
#pragma unroll
    for (int a = 0; a < 2; ++a)
#pragma unroll
        for (int b = 0; b < 2; ++b)
#pragma unroll
            for (int m = 0; m < 4; ++m)
#pragma unroll
                for (int n = 0; n < 2; ++n) acc[a][b][m][n] = (f32x4){0.f, 0.f, 0.f, 0.f};
    bf16x8 At[4][2], B0[2][2], B1[2][2];
    const char* cA = (const char*)g.A + (size_t)cur.pm * tstep; const char* cB = (const char*)g.Bt + (size_t)cur.pn * tstep;
    S.a_ready(cur);
    if constexpr (SP2) {
        PG8_STAGE(PG8_SB(0, 0), cB, voffB); PG8_STAGE(PG8_SB(0, 1), cB + hstep, voffB); PG8_STAGE(PG8_SA(0, 0), cA, voffA); PG8_STAGE(PG8_SA(0, 1), cA + hstep, voffA);
        if (wr == 1) PG8_BAR;
        PG8_WAIT_V(2); PG8_BAR;
        PG8_STAGE(PG8_SB(1, 0), cB + kstep, voffB); PG8_STAGE(PG8_SA(1, 0), cA + kstep, voffA); PG8_STAGE(PG8_SB(1, 1), cB + hstep + kstep, voffB);
        PG8_WAIT_V(6); PG8_BAR;
    } else {
        PG8_STAGE(PG8_SB(0, 0), cB, voffB); PG8_STAGE(PG8_SA(0, 0), cA, voffA); PG8_STAGE(PG8_SB(0, 1), cB + hstep, voffB); PG8_STAGE(PG8_SA(0, 1), cA + hstep, voffA);
        if (wr == 1) PG8_BAR;
        PG8_WAIT_V(4); PG8_BAR;
        PG8_STAGE(PG8_SB(1, 0), cB + kstep, voffB); PG8_STAGE(PG8_SA(1, 0), cA + kstep, voffA); PG8_STAGE(PG8_SB(1, 1), cB + hstep + kstep, voffB);
        PG8_WAIT_V(6); PG8_BAR;
    }
    for (;;) {
        const bool has_next = S.next(ui + 1, nxt);
        const char* nA = has_next ? (const char*)g.A + (size_t)nxt.pm * tstep : cA; const char* nB = has_next ? (const char*)g.Bt + (size_t)nxt.pn * tstep : cB;
        for (int t = 0; t < nt; t += 2) {
            const bool last = (t == nt - 2);
            const char* a1 = cA + (size_t)(t + 1) * kstep;
            const char* a2 = last ? nA : cA + (size_t)(t + 2) * kstep; const char* b2 = last ? nB : cB + (size_t)(t + 2) * kstep;
            const char* a3 = a2 + kstep; const char* b3 = b2 + kstep;
            if (last && has_next) S.a_ready(nxt);
            if constexpr (SP2) {
            PG8_LDB(B0, 0, 0); PG8_LDB(B1, 0, 1); PG8_SCHED; PG8_LDA(At, 0, 0); PG8_STAGE(PG8_SA(1, 1), a1 + hstep, voffA);
            PG8_WAIT_V(8); PG8_WAIT_L(0); PG8_BAR; PG8_MMA(0, 0, At, B0); PG8_MMA(0, 1, At, B1); PG8_BAR; PG8_SCHED;
            PG8_LDA(At, 0, 1); PG8_STAGE(PG8_SB(0, 0), b2, voffB); PG8_STAGE(PG8_SB(0, 1), b2 + hstep, voffB); PG8_STAGE(PG8_SA(0, 0), a2, voffA);
            PG8_WAIT_V(8); PG8_WAIT_L(0); PG8_BAR; PG8_MMA(1, 0, At, B0); PG8_MMA(1, 1, At, B1); PG8_BAR; PG8_SCHED;
            PG8_LDB(B0, 1, 0); PG8_LDB(B1, 1, 1); PG8_SCHED; PG8_LDA(At, 1, 0); PG8_STAGE(PG8_SA(0, 1), a2 + hstep, voffA);
            PG8_WAIT_V(8); PG8_WAIT_L(0); PG8_BAR; PG8_MMA(0, 0, At, B0); PG8_MMA(0, 1, At, B1); PG8_BAR; PG8_SCHED;
            PG8_LDA(At, 1, 1); PG8_STAGE(PG8_SB(1, 0), b3, voffB); PG8_STAGE(PG8_SB(1, 1), b3 + hstep, voffB); PG8_STAGE(PG8_SA(1, 0), a3, voffA);
            PG8_WAIT_V(8); PG8_WAIT_L(0); PG8_BAR; PG8_MMA(1, 0, At, B0); PG8_MMA(1, 1, At, B1); PG8_BAR; PG8_SCHED;
            } else {
            PG8_LDB(B0, 0, 0); PG8_SCHED; PG8_LDA(At, 0, 0); PG8_STAGE(PG8_SA(1, 1), a1 + hstep, voffA);
            PG8_WAIT_L(8); PG8_BAR; PG8_WAIT_L(0); PG8_MMA(0, 0, At, B0); PG8_BAR; PG8_SCHED;
            PG8_LDB(B1, 0, 1); PG8_STAGE(PG8_SB(0, 0), b2, voffB);
            PG8_BAR; PG8_WAIT_L(0); PG8_MMA(0, 1, At, B1); PG8_BAR;
            PG8_LDA(At, 0, 1); PG8_STAGE(PG8_SA(0, 0), a2, voffA);
            PG8_BAR; PG8_WAIT_L(0); PG8_MMA(1, 0, At, B0); PG8_BAR; PG8_SCHED;
            PG8_STAGE(PG8_SB(0, 1), b2 + hstep, voffB);
            PG8_WAIT_V(6); PG8_BAR; PG8_MMA(1, 1, At, B1); PG8_BAR;
            PG8_LDB(B0, 1, 0); PG8_SCHED; PG8_LDA(At, 1, 0); PG8_STAGE(PG8_SA(0, 1), a2 + hstep, voffA);
            PG8_WAIT_L(8); PG8_BAR; PG8_WAIT_L(0); PG8_MMA(0, 0, At, B0); PG8_BAR; PG8_SCHED;
            PG8_LDB(B1, 1, 1); PG8_STAGE(PG8_SB(1, 0), b3, voffB);
            PG8_BAR; PG8_WAIT_L(0); PG8_MMA(0, 1, At, B1); PG8_BAR;
            PG8_LDA(At, 1, 1); PG8_STAGE(PG8_SA(1, 0), a3, voffA);
            PG8_BAR; PG8_WAIT_L(0); PG8_MMA(1, 0, At, B0); PG8_BAR; PG8_SCHED;
            PG8_STAGE(PG8_SB(1, 1), b3 + hstep, voffB);
            PG8_WAIT_V(6); PG8_BAR; PG8_MMA(1, 1, At, B1); PG8_BAR;
            }
        }
        if constexpr (ALIGN_EPI) { if (wr == 0) PG8_BAR; }
        if constexpr (!Epi::AFTER_DRAIN) { E(acc, cur, wr, wc, fr, fq); S.done(cur); }
        if (!has_next) break;
#pragma unroll
        for (int a = 0; a < 2; ++a)
#pragma unroll
            for (int b = 0; b < 2; ++b)
#pragma unroll
                for (int m = 0; m < 4; ++m)
#pragma unroll
                    for (int n = 0; n < 2; ++n) acc[a][b][m][n] = (f32x4){0.f, 0.f, 0.f, 0.f};
        cur = nxt; cA = nA; cB = nB; ++ui;
        if constexpr (ALIGN_EPI) { if (wr == 1) PG8_BAR; }
    }
    PG8_WAIT_V(0);
    if constexpr (!ALIGN_EPI) { if (wr == 0) PG8_BAR; }
    PG8_BAR;
    if constexpr (Epi::AFTER_DRAIN) { E.fused(acc, cur, wr, wc, fr, fq, lds, wid, lane); S.done(cur); }
#undef PG8_SA
#undef PG8_SB
#undef PG8_STAGE
#undef PG8_LDA
#undef PG8_LDB
#undef PG8_MMA
#undef PG8_WAIT_V
#undef PG8_WAIT_L
#undef PG8_BAR
#undef PG8_SCHED
}
}

#ifndef PG8_SP2
#define PG8_SP2 true
#endif
#ifndef PG8_ALIGN
#define PG8_ALIGN true
#endif
#ifndef MK_N_LAUNCHES
#define MK_N_LAUNCHES 0
#endif
constexpr int NWAVES = 8;
constexpr int D = 1024, TP = 32768, TS = 16384, T = TP + TS, NSEQ = 9, FF = 2816, NH = 16, NGRP = T / 64, MODW = 6 * D;
constexpr float RMS_EPS = 1e-6f;
constexpr int NPH = 18;

constexpr size_t MiB = 1u << 20;
constexpr size_t WS_CTL = 0, CTL_ZERO_BYTES = 1 * MiB, WS_MOD = 512 * 1024;
constexpr size_t WS_WQKV = 2 * MiB, WS_WO = 8 * MiB, WS_WIN = 10 * MiB, WS_WOUT = 16 * MiB, WS_WUP0 = 18 * MiB, WS_WUP1 = 29 * MiB, WS_WDN0 = 40 * MiB, WS_WDN1 = 46 * MiB;
constexpr size_t WS_H = 52 * MiB;
constexpr size_t WS_Q = 148 * MiB;
constexpr size_t WS_VT = WS_Q + (size_t)T * 2048 * 2;
constexpr size_t WS_EDGE = 436 * MiB;
constexpr size_t WS_END = WS_EDGE + 6 * (size_t)NGRP * FF * 4;
static_assert(WS_MOD + 2 * NSEQ * MODW * 4 <= CTL_ZERO_BYTES && WS_WDN1 + (size_t)D * FF * 2 <= WS_H && WS_H + (size_t)T * D * 2 <= WS_Q && WS_Q + (size_t)T * 3072 * 2 <= WS_EDGE && WS_END <= 512 * MiB, "d_ws map");

constexpr int RING_BYTES = 131072, LDS_BYTES = 147456;

#define GAS __attribute__((address_space(1)))
#define LAS __attribute__((address_space(3)))
typedef unsigned short bf16;
typedef unsigned v4u __attribute__((ext_vector_type(4)));
typedef unsigned v2u __attribute__((ext_vector_type(2)));
typedef float f32x4 __attribute__((ext_vector_type(4)));
typedef short bf16x8 __attribute__((ext_vector_type(8)));
#define LDS_WAIT() asm volatile("s_waitcnt lgkmcnt(0)" ::: "memory")
__device__ __forceinline__ unsigned f2bf(float f) { unsigned u = __builtin_bit_cast(unsigned, f); return (u + 0x7fffu + ((u >> 16) & 1u)) >> 16; }
__device__ __forceinline__ unsigned pk2(float lo, float hi) { return f2bf(lo) | (f2bf(hi) << 16); }
__device__ __forceinline__ float bflo(unsigned w) { return __builtin_bit_cast(float, w << 16); }
__device__ __forceinline__ float bfhi(unsigned w) { return __builtin_bit_cast(float, w & 0xffff0000u); }
__device__ __forceinline__ float wave_sum(float v) {
#pragma unroll
    for (int o = 1; o < 64; o <<= 1) v += __shfl_xor(v, o);
    return v;
}

struct Frame {
    LAS unsigned char* lds;
    int tid, lane, wave, G;
    const float* in[20]; float* out; unsigned char* ws;
};

__device__ __forceinline__ void p0_transpose_item(const float* W, int N, int K, bf16* WT, int drow0, int k0, int n0, LAS float* scr, int lane) {
#pragma unroll 8
    for (int i = 0; i < 32; ++i) { const int kk = 2 * i + (lane >> 5); scr[kk * 33 + (lane & 31)] = W[(size_t)(k0 + kk) * N + n0 + (lane & 31)]; }
    LDS_WAIT(); asm volatile("" ::: "memory");
    const int c = lane & 7;
#pragma unroll
    for (int j = 0; j < 4; ++j) { const int n = (lane >> 3) + 8 * j; const LAS float* s = scr + (8 * c) * 33 + n;
        v4u o; o.x = pk2(s[0 * 33], s[1 * 33]); o.y = pk2(s[2 * 33], s[3 * 33]); o.z = pk2(s[4 * 33], s[5 * 33]); o.w = pk2(s[6 * 33], s[7 * 33]);
        *(v4u*)(WT + (size_t)(drow0 + n) * K + k0 + 8 * c) = o; }
    LDS_WAIT(); asm volatile("" ::: "memory");
}
__device__ __forceinline__ void p0_prologue(Frame& F) {
    LAS float* sc = (LAS float*)F.lds;
    float* mod = (float*)(F.ws + WS_MOD);
    if (blockIdx.x < 192) {
        const float* cp = F.in[2]; const float* cs = F.in[3];
        for (int i = F.tid; i < NSEQ * D; i += NWAVES * 64) { const float v = i < 8 * D ? cp[i] : cs[i - 8 * D]; sc[i] = v / (1.0f + __expf(-v)); }
        __syncthreads();
        const int id = blockIdx.x * 512 + F.tid, ks = id / 12288, ln = id % 12288, l = ln / MODW, n = ln % MODW;
        const float* w = F.in[4] + ((size_t)l * D + ks * 128) * MODW + n;
        const LAS float* sk = sc + ks * 128;
        float a0 = 0.f, a1 = 0.f, a2 = 0.f, a3 = 0.f, a4 = 0.f, a5 = 0.f, a6 = 0.f, a7 = 0.f, a8 = 0.f;
#pragma unroll 8
        for (int k = 0; k < 128; ++k) { const float wv = w[(size_t)k * MODW];
            a0 += sk[k] * wv; a1 += sk[D + k] * wv; a2 += sk[2 * D + k] * wv; a3 += sk[3 * D + k] * wv; a4 += sk[4 * D + k] * wv;
            a5 += sk[5 * D + k] * wv; a6 += sk[6 * D + k] * wv; a7 += sk[7 * D + k] * wv; a8 += sk[8 * D + k] * wv; }
        const float bias = ks == 0 ? F.in[5][l * MODW + n] : 0.f;
        float* mo = mod + (size_t)l * NSEQ * MODW + n;
        atomicAdd(mo + 0 * MODW, a0 + bias); atomicAdd(mo + 1 * MODW, a1 + bias); atomicAdd(mo + 2 * MODW, a2 + bias); atomicAdd(mo + 3 * MODW, a3 + bias); atomicAdd(mo + 4 * MODW, a4 + bias);
        atomicAdd(mo + 5 * MODW, a5 + bias); atomicAdd(mo + 6 * MODW, a6 + bias); atomicAdd(mo + 7 * MODW, a7 + bias); atomicAdd(mo + 8 * MODW, a8 + bias);
    }
    __syncthreads();
    LAS float* scr = (LAS float*)(F.lds + F.wave * 16384);
    const int gw = blockIdx.x * NWAVES + F.wave, NGW = F.G * NWAVES;
    constexpr int I_QKV = 16 * 96, I_O = 16 * 32, I_UP = 16 * 176, I_DN = 44 * 32;
    constexpr int NITEMS = 2 * I_QKV + 2 * I_O + 2 * I_UP + 2 * I_DN;
    for (int it = gw; it < NITEMS; it += NGW) {
        int r = it;
        if (r < I_QKV) { const int kb = r / 96, nb = r % 96; p0_transpose_item(F.in[8], 3072, D, (bf16*)(F.ws + WS_WQKV), 32 * nb, 64 * kb, 32 * nb, scr, F.lane); continue; } r -= I_QKV;
        if (r < I_QKV) { const int kb = r / 96, nb = r % 96; p0_transpose_item(F.in[12], 3072, D, (bf16*)(F.ws + WS_WIN), 32 * nb, 64 * kb, 32 * nb, scr, F.lane); continue; } r -= I_QKV;
        if (r < I_O) { const int kb = r / 32, nb = r % 32; p0_transpose_item(F.in[11], D, D, (bf16*)(F.ws + WS_WO), 32 * nb, 64 * kb, 32 * nb, scr, F.lane); continue; } r -= I_O;
        if (r < I_O) { const int kb = r / 32, nb = r % 32; p0_transpose_item(F.in[14], D, D, (bf16*)(F.ws + WS_WOUT), 32 * nb, 64 * kb, 32 * nb, scr, F.lane); continue; } r -= I_O;
        if (r < 2 * I_UP) { const int l = r / I_UP; r -= l * I_UP; const int kb = r / 176, nb = r % 176, n0 = 32 * nb;
            const int n1 = n0 < FF ? n0 : n0 - FF; const int drow = 256 * (n1 / 128) + (n0 < FF ? 0 : 128) + (n1 % 128);
            p0_transpose_item(F.in[15] + (size_t)l * D * 2 * FF, 2 * FF, D, (bf16*)(F.ws + (l ? WS_WUP1 : WS_WUP0)), drow, 64 * kb, n0, scr, F.lane); continue; } r -= 2 * I_UP;
        { const int l = r / I_DN; r -= l * I_DN; const int kb = r / 32, nb = r % 32;
            p0_transpose_item(F.in[18] + (size_t)l * FF * D, D, FF, (bf16*)(F.ws + (l ? WS_WDN1 : WS_WDN0)), 32 * nb, 64 * kb, 32 * nb, scr, F.lane); }
    }
}

template <int MODE>
__device__ __forceinline__ void norm_phase(Frame& F, bool from_input, const float* g, const float* modl, int sh_idx, int sc_idx, bf16* H) {
    const int lane = F.lane;
    for (int chunk = blockIdx.x; chunk < NGRP; chunk += F.G) {
        const int s = pg8::seq_of_row(chunk * 64);
        f32x4 gs[4], sh[4];
#pragma unroll
        for (int j = 0; j < 4; ++j) { const int col = 4 * lane + 256 * j; const f32x4 gv = *(const f32x4*)(g + col);
            if (MODE == 0) { const f32x4 scv = *(const f32x4*)(modl + s * MODW + sc_idx * D + col); sh[j] = *(const f32x4*)(modl + s * MODW + sh_idx * D + col); gs[j] = gv * (scv + 1.0f); }
            else { gs[j] = gv; sh[j] = (f32x4){0.f, 0.f, 0.f, 0.f}; } }
#pragma unroll 2
        for (int i = 0; i < 8; ++i) {
            const int m = chunk * 64 + F.wave * 8 + i;
            const float* xr = from_input ? (m < TP ? F.in[0] + (size_t)m * D : F.in[1] + (size_t)(m - TP) * D) : F.out + (size_t)m * D;
            f32x4 v[4]; float ss = 0.f;
#pragma unroll
            for (int j = 0; j < 4; ++j) { v[j] = *(const f32x4*)(xr + 4 * lane + 256 * j); ss += (v[j].x * v[j].x + v[j].y * v[j].y) + (v[j].z * v[j].z + v[j].w * v[j].w); }
            const float rstd = rsqrtf(wave_sum(ss) * (1.0f / D) + RMS_EPS);
            if (MODE == 0) {
                bf16* hr = H + (size_t)m * D + 4 * lane;
#pragma unroll
                for (int j = 0; j < 4; ++j) { const f32x4 o = v[j] * rstd * gs[j] + sh[j]; v2u w; w.x = pk2(o.x, o.y); w.y = pk2(o.z, o.w); *(v2u*)(hr + 256 * j) = w; }
            } else {
                float* orow = F.out + (size_t)m * D + 4 * lane;
#pragma unroll
                for (int j = 0; j < 4; ++j) *(f32x4*)(orow + 256 * j) = v[j] * rstd * gs[j];
            }
        }
    }
}

__device__ __forceinline__ void na_phase(Frame& F, const bf16* QK, const bf16* VT, const float* rpb, bf16* O) {
    LAS float* tab = (LAS float*)F.lds;
    for (int i = F.tid; i < NH * 465; i += NWAVES * 64) tab[i] = rpb[i];
    __syncthreads();
    const int lane = F.lane, q = lane & 15, g = lane >> 4;
    for (int u = blockIdx.x; u < 256; u += F.G) {
        const int hh = u & 15, chunk = u >> 4;
        for (int it = 0; it < 24; ++it) {
            const int blk = it * 8 + F.wave, grl = blk >> 2, j = blk & 3, gr = chunk * 48 + grl;
            int base, r, rows; if (gr < 512) { base = gr & ~63; r = gr & 63; rows = 64; } else { base = 512; r = gr - 512; rows = 256; }
            int rs = r - 4; rs = rs < 0 ? 0 : rs; rs = rs > rows - 8 ? rows - 8 : rs;
            const int krow0 = base + rs, dr0 = rs - r + 7;
            const int bs = j == 0 ? 0 : (j == 3 ? 32 : 16 * j - 8);
            const int qcol = 16 * j + q; const size_t qtok = (size_t)gr * 64 + qcol;
            const bf16* qp = QK + qtok * 2048 + hh * 64 + 8 * g;
            const bf16x8 qf0 = *(const bf16x8*)qp, qf1 = *(const bf16x8*)(qp + 32);
            f32x4 S[8][2];
            const int kc0 = bs + 8 * (q >> 2) + (q & 3);
            const bf16* kp = QK + ((size_t)krow0 * 64 + kc0) * 2048 + 1024 + hh * 64 + 8 * g;
#pragma unroll
            for (int kr = 0; kr < 8; ++kr)
#pragma unroll
                for (int p = 0; p < 2; ++p) { const bf16* a = kp + ((size_t)kr * 64 + 4 * p) * 2048; const bf16x8 k0 = *(const bf16x8*)a, k1 = *(const bf16x8*)(a + 32);
                    f32x4 z = (f32x4){0.f, 0.f, 0.f, 0.f}; z = __builtin_amdgcn_mfma_f32_16x16x32_bf16(k0, qf0, z, 0, 0, 0); z = __builtin_amdgcn_mfma_f32_16x16x32_bf16(k1, qf1, z, 0, 0, 0); S[kr][p] = z; }
            int cs = qcol - 8; cs = cs < 0 ? 0 : cs; cs = cs > 48 ? 48 : cs;
            const int kcb = bs + 8 * g; float mx = -3.0e38f;
            const LAS float* tb = tab + hh * 465 + dr0 * 31;
#pragma unroll
            for (int kr = 0; kr < 8; ++kr)
#pragma unroll
                for (int p = 0; p < 2; ++p)
#pragma unroll
                    for (int i = 0; i < 4; ++i) { const int kc = kcb + 4 * p + i; int dc = kc - qcol + 15; dc = dc < 0 ? 0 : dc; dc = dc > 30 ? 30 : dc;
                        const float b = tb[kr * 31 + dc]; const bool valid = (kc >= cs) && (kc < cs + 16);
                        const float sv = valid ? S[kr][p][i] + b : -1.0e30f; S[kr][p][i] = sv; mx = fmaxf(mx, sv); }
            mx = fmaxf(mx, __shfl_xor(mx, 16)); mx = fmaxf(mx, __shfl_xor(mx, 32));
            float sum = 0.f;
#pragma unroll
            for (int kr = 0; kr < 8; ++kr)
#pragma unroll
                for (int p = 0; p < 2; ++p)
#pragma unroll
                    for (int i = 0; i < 4; ++i) { const float e = __expf(S[kr][p][i] - mx); S[kr][p][i] = e; sum += e; }
            sum += __shfl_xor(sum, 16); sum += __shfl_xor(sum, 32);
            const float inv = 1.0f / sum;
            f32x4 Oa[4];
#pragma unroll
            for (int dt = 0; dt < 4; ++dt) Oa[dt] = (f32x4){0.f, 0.f, 0.f, 0.f};
            const bf16* vp = VT + (size_t)(hh * 64 + q) * T + (size_t)krow0 * 64 + bs + 8 * g;
#pragma unroll
            for (int kr = 0; kr < 8; ++kr) {
                v4u pw; pw.x = pk2(S[kr][0][0], S[kr][0][1]); pw.y = pk2(S[kr][0][2], S[kr][0][3]); pw.z = pk2(S[kr][1][0], S[kr][1][1]); pw.w = pk2(S[kr][1][2], S[kr][1][3]);
                const bf16x8 pf = __builtin_bit_cast(bf16x8, pw);
#pragma unroll
                for (int dt = 0; dt < 4; ++dt) { const bf16x8 vf = *(const bf16x8*)(vp + (size_t)dt * 16 * T + kr * 64); Oa[dt] = __builtin_amdgcn_mfma_f32_16x16x32_bf16(vf, pf, Oa[dt], 0, 0, 0); }
            }
            bf16* op = O + qtok * D + hh * 64 + 4 * g;
#pragma unroll
            for (int dt = 0; dt < 4; ++dt) { v2u w; w.x = pk2(Oa[dt][0] * inv, Oa[dt][1] * inv); w.y = pk2(Oa[dt][2] * inv, Oa[dt][3] * inv); *(v2u*)(op + 16 * dt) = w; }
        }
    }
    __syncthreads();
}

__device__ __forceinline__ void edge_phase(Frame& F, const float* cw, bf16* G) {
    constexpr size_t ES = (size_t)NGRP * FF; const float* edge = (const float*)(F.ws + WS_EDGE);
    const int nth = F.G * NWAVES * 64;
    for (int id = blockIdx.x * (NWAVES * 64) + F.tid; id < NGRP * (FF / 4); id += nth) {
        const int g = id / (FF / 4), c = 4 * (id % (FF / 4));
        const bool sstart = g < 512 ? ((g & 63) == 0) : (g == 512), send = g < 512 ? ((g & 63) == 63) : (g == NGRP - 1);
        const size_t e = (size_t)g * FF + c;
        { f32x4 pre = *(const f32x4*)(edge + 2 * ES + e); if (!sstart) pre = pre + *(const f32x4*)(cw + c) * *(const f32x4*)(edge + 1 * ES + e - FF);
          const f32x4 o = pg8::silu4(pre) * *(const f32x4*)(edge + 4 * ES + e); v2u w; w.x = pk2(o.x, o.y); w.y = pk2(o.z, o.w); *(v2u*)(G + (size_t)(64 * g) * FF + c) = w; }
        { f32x4 pre = *(const f32x4*)(edge + 3 * ES + e); if (!send) pre = pre + *(const f32x4*)(cw + 2 * FF + c) * *(const f32x4*)(edge + 0 * ES + e + FF);
          const f32x4 o = pg8::silu4(pre) * *(const f32x4*)(edge + 5 * ES + e); v2u w; w.x = pk2(o.x, o.y); w.y = pk2(o.z, o.w); *(v2u*)(G + (size_t)(64 * g + 63) * FF + c) = w; }
    }
}

__device__ __forceinline__ void zrow(const bf16* BCU, int t, int lo, int hi, int c, float (&z)[8]) {
    if (t < lo || t >= hi) {
#pragma unroll
        for (int i = 0; i < 8; ++i) z[i] = 0.f;
        return; }
    const v4u a = *(const v4u*)(BCU + (size_t)t * 3072 + D + c), b = *(const v4u*)(BCU + (size_t)t * 3072 + 2 * D + c);
    z[0] = bflo(a.x) * bflo(b.x); z[1] = bfhi(a.x) * bfhi(b.x); z[2] = bflo(a.y) * bflo(b.y); z[3] = bfhi(a.y) * bfhi(b.y);
    z[4] = bflo(a.z) * bflo(b.z); z[5] = bfhi(a.z) * bfhi(b.z); z[6] = bflo(a.w) * bflo(b.w); z[7] = bfhi(a.w) * bfhi(b.w);
}
__device__ __forceinline__ void sconv_phase(Frame& F, const bf16* BCU, const float* cw, bf16* Y) {
    const int cgp = F.tid & 127, rq = F.tid >> 7, c = 8 * cgp;
    float w0[8], w1[8], w2[8];
#pragma unroll
    for (int i = 0; i < 8; ++i) { w0[i] = cw[c + i]; w1[i] = cw[D + c + i]; w2[i] = cw[2 * D + c + i]; }
    for (int chunk = blockIdx.x; chunk < NGRP; chunk += F.G) {
        const int t0 = chunk * 64 + rq * 16;
        const int lo = t0 < TP ? (t0 & ~4095) : TP, hi = t0 < TP ? lo + 4096 : T;
        float zp[8], zc[8], zn[8];
        zrow(BCU, t0 - 1, lo, hi, c, zp); zrow(BCU, t0, lo, hi, c, zc);
#pragma unroll 4
        for (int i = 0; i < 16; ++i) {
            const int t = t0 + i;
            zrow(BCU, t + 1, lo, hi, c, zn);
            const v4u bgw = *(const v4u*)(BCU + (size_t)t * 3072 + c);
            float y[8];
#pragma unroll
            for (int k = 0; k < 8; ++k) y[k] = w0[k] * zp[k] + w1[k] * zc[k] + w2[k] * zn[k];
            v4u o; o.x = pk2(y[0] * bflo(bgw.x), y[1] * bfhi(bgw.x)); o.y = pk2(y[2] * bflo(bgw.y), y[3] * bfhi(bgw.y));
            o.z = pk2(y[4] * bflo(bgw.z), y[5] * bfhi(bgw.z)); o.w = pk2(y[6] * bflo(bgw.w), y[7] * bfhi(bgw.w));
            *(v4u*)(Y + (size_t)t * D + c) = o;
#pragma unroll
            for (int k = 0; k < 8; ++k) { zp[k] = zc[k]; zc[k] = zn[k]; }
        }
    }
}

struct Args { const float* in[20]; float* out; unsigned char* ws; int ph_lo, ph_hi; };
__global__ void __launch_bounds__(NWAVES * 64, 2) mk_fwd(Args args) {
    extern __shared__ __attribute__((aligned(16))) unsigned char lds[];
    Frame F;
    F.lds = (LAS unsigned char*)lds;
    F.tid = threadIdx.x; F.lane = F.tid & 63; F.wave = __builtin_amdgcn_readfirstlane(F.tid >> 6); F.G = gridDim.x;
#pragma unroll
    for (int i = 0; i < 20; ++i) F.in[i] = args.in[i];
    F.out = args.out; F.ws = args.ws;
    unsigned char* ws = args.ws;
    bf16* const Wqkv = (bf16*)(ws + WS_WQKV); bf16* const Wo = (bf16*)(ws + WS_WO); bf16* const Win = (bf16*)(ws + WS_WIN); bf16* const Wout = (bf16*)(ws + WS_WOUT);
    bf16* const H = (bf16*)(ws + WS_H); bf16* const QK = (bf16*)(ws + WS_Q); bf16* const VT = (bf16*)(ws + WS_VT); bf16* const BCU = (bf16*)(ws + WS_Q); bf16* const Gb = (bf16*)(ws + WS_Q);
    const float* mod = (const float*)(ws + WS_MOD);
    const int lo = args.ph_lo, hi = args.ph_hi;
#define IN(k) (lo <= (k) && (k) < hi)
#define SEAM(k) do { if (IN(k) && IN((k) + 1)) { cg::this_grid().sync(); } } while (0)
#define GEMM_PHASE(EPI, A_, B_, M_, N_, K_, E_) do { pg8::Gemm g_{(const pg8::bf16_t*)(A_), (const pg8::bf16_t*)(B_), (M_), (N_), (K_)}; pg8::StaticOrder S_; S_.init((M_), (N_), F.G, (int)blockIdx.x); \
        pg8::gemm_phase<EPI, pg8::StaticOrder, PG8_ALIGN, PG8_SP2>(F.lds, g_, S_, E_); } while (0)

    if (IN(0)) { p0_prologue(F); } SEAM(0);
    if (IN(1)) { norm_phase<0>(F, true, F.in[6], mod, 0, 1, H); } SEAM(1);
    if (IN(2)) {
        { pg8::EpiBf16<0> E{(pg8::bf16_t*)QK, 2048, F.in[9], 1024, (size_t)1024, 0.125f}; GEMM_PHASE(pg8::EpiBf16<0>, H, Wqkv, T, 2048, D, E); }
        { pg8::EpiBf16RowBias E{(pg8::bf16_t*)VT, T, F.in[9] + 2048}; GEMM_PHASE(pg8::EpiBf16RowBias, Wqkv + (size_t)2048 * D, H, D, T, D, E); }
    } SEAM(2);
    if (IN(3)) { na_phase(F, QK, VT, F.in[10], H); } SEAM(3);
    if (IN(4)) { pg8::EpiResGate E{F.in[0], F.in[1], F.out, mod + 2 * D}; GEMM_PHASE(pg8::EpiResGate, H, Wo, T, D, D, E); } SEAM(4);
    if (IN(5)) { norm_phase<0>(F, false, F.in[7], mod, 3, 4, H); } SEAM(5);
    if (IN(6)) { pg8::EpiGate E{(pg8::bf16_t*)Gb, F.in[16], F.in[17], (float*)(ws + WS_EDGE)}; GEMM_PHASE(pg8::EpiGate, H, ws + WS_WUP0, T, 2 * FF, D, E); } SEAM(6);
    if (IN(7)) { edge_phase(F, F.in[16], Gb); } SEAM(7);
    if (IN(8)) { pg8::EpiResGate E{F.out, F.out + (size_t)TP * D, F.out, mod + 5 * D}; GEMM_PHASE(pg8::EpiResGate, Gb, ws + WS_WDN0, T, D, FF, E); } SEAM(8);
    const float* mod1 = mod + NSEQ * MODW;
    if (IN(9)) { norm_phase<0>(F, false, F.in[6] + D, mod1, 0, 1, H); } SEAM(9);
    if (IN(10)) { pg8::EpiBf16<0> E{(pg8::bf16_t*)BCU, 3072, nullptr, 0, (size_t)0, 1.f}; GEMM_PHASE(pg8::EpiBf16<0>, H, Win, T, 3072, D, E); } SEAM(10);
    if (IN(11)) { sconv_phase(F, BCU, F.in[13], H); } SEAM(11);
    if (IN(12)) { pg8::EpiResGate E{F.out, F.out + (size_t)TP * D, F.out, mod1 + 2 * D}; GEMM_PHASE(pg8::EpiResGate, H, Wout, T, D, D, E); } SEAM(12);
    if (IN(13)) { norm_phase<0>(F, false, F.in[7] + D, mod1, 3, 4, H); } SEAM(13);
    if (IN(14)) { pg8::EpiGate E{(pg8::bf16_t*)Gb, F.in[16] + 3 * FF, F.in[17] + FF, (float*)(ws + WS_EDGE)}; GEMM_PHASE(pg8::EpiGate, H, ws + WS_WUP1, T, 2 * FF, D, E); } SEAM(14);
    if (IN(15)) { edge_phase(F, F.in[16] + 3 * FF, Gb); } SEAM(15);
    if (IN(16)) { pg8::EpiResGate E{F.out, F.out + (size_t)TP * D, F.out, mod1 + 5 * D}; GEMM_PHASE(pg8::EpiResGate, Gb, ws + WS_WDN1, T, D, FF, E); } SEAM(16);
    if (IN(17)) { norm_phase<1>(F, false, F.in[19], mod, 0, 0, H); }
#undef IN
#undef SEAM
#undef GEMM_PHASE
}

extern "C" void kernel_launch(void* const* d_in, const int* in_sizes, int n_in, void* d_out, int out_size, void* d_ws, size_t ws_size, hipStream_t stream) {
    static int grid = 0;
    if (grid == 0) {
        if (n_in != 20 || out_size != T * D || ws_size < WS_END) { fprintf(stderr, "kernel_launch: unexpected shapes: n_in %d out %d ws %zu (need %zu)\n", n_in, out_size, ws_size, (size_t)WS_END); grid = -1; return; }
        int dev = 0, cus = 0, per_cu = 0;
        (void)hipGetDevice(&dev); (void)hipDeviceGetAttribute(&cus, hipDeviceAttributeMultiprocessorCount, dev);
        if (hipFuncSetAttribute((const void*)mk_fwd, hipFuncAttributeMaxDynamicSharedMemorySize, LDS_BYTES) != hipSuccess) { fprintf(stderr, "kernel_launch: hipFuncSetAttribute failed\n"); grid = -1; return; }
        if (hipOccupancyMaxActiveBlocksPerMultiprocessor(&per_cu, (const void*)mk_fwd, NWAVES * 64, LDS_BYTES) != hipSuccess || per_cu < 1) { fprintf(stderr, "kernel_launch: occupancy query says %d\n", per_cu); per_cu = 1; }
        (void)hipGetLastError();
        grid = cus * 1;
        fprintf(stderr, "kernel_launch: cus %d per_cu %d grid %d\n", cus, per_cu, grid);
    }
    if (grid < 0) return;
    (void)hipMemsetAsync((char*)d_ws + WS_CTL, 0, CTL_ZERO_BYTES, stream);
    Args a{};
    for (int i = 0; i < 20; ++i) a.in[i] = (const float*)d_in[i];
    a.out = (float*)d_out; a.ws = (unsigned char*)d_ws;
#if MK_N_LAUNCHES == 1
    a.ph_lo = 0; a.ph_hi = NPH;
    void* kargs[] = {&a};
    hipError_t e = hipLaunchCooperativeKernel((const void*)mk_fwd, dim3(grid), dim3(NWAVES * 64), kargs, LDS_BYTES, stream);
    if (e != hipSuccess) fprintf(stderr, "kernel_launch: cooperative launch failed: %s (grid %d)\n", hipGetErrorString(e), grid);
#else
    for (int p = 0; p < NPH; ++p) { a.ph_lo = p; a.ph_hi = p + 1; hipLaunchKernelGGL(mk_fwd, dim3(grid), dim3(NWAVES * 64), LDS_BYTES, stream, a); }
#endif
}
```
